# Optimizing an MI355X kernel written in HIP

```python
import jax, jax.numpy as jnp
from jax import lax
import numpy as np

D_MODEL = 1024
BATCH = 8
SEQ = 2048
DEPTH = 4
DEC_BATCH = 128
DEC_SEQ = 4
PAST_LEN = 16384
PAGE_SIZE = 128

N_MIXERS = 2
N_LRU_LAYERS = (DEPTH + 1) // 2
N_SG_LAYERS = DEPTH // 2
D_RNN = 3 * D_MODEL // 2
N_LRU_HEADS = 16
LRU_BLOCK = D_RNN // N_LRU_HEADS
CONV_W = 4
LRU_C = 8.0
CHUNK = 128
D_SG = 3 * D_MODEL // 2
N_SG_GROUPS = 16
SG_GROUP = D_SG // N_SG_GROUPS
D_FF = 4 * D_MODEL
EPS = 1e-6

kernel_name = "hawk_gmlp_interleaved_decoder_step"


def rmsnorm(x, g):
    xf = x.astype(jnp.float32)
    y = xf * lax.rsqrt(jnp.mean(xf * xf, axis=-1, keepdims=True) + EPS)
    return (y * g.astype(jnp.float32)).astype(x.dtype)


def layernorm(x, g, b):
    xf = x.astype(jnp.float32)
    mu = jnp.mean(xf, axis=-1, keepdims=True)
    xc = xf - mu
    var = jnp.mean(xc * xc, axis=-1, keepdims=True)
    y = xc * lax.rsqrt(var + EPS) * g.astype(jnp.float32) + b.astype(jnp.float32)
    return y.astype(x.dtype)


def ada_params(c, w, b):
    mod = jax.nn.silu(c) @ w + b
    return jnp.split(mod[:, None, :], 6, axis=-1)


def causal_conv(xb, buf, w, b):
    t = xb.shape[1]
    xp = jnp.concatenate([buf.astype(xb.dtype), xb], axis=1)
    y = b
    for k in range(CONV_W):
        y = y + xp[:, k:k + t] * w[k]
    return y, xp[:, -(CONV_W - 1):]


def _lin_comb(left, right):
    a1, b1 = left
    a2, b2 = right
    return a1 * a2, a2 * b1 + b2


def rglru_mixer(h, conv_buf, h0, w_in, conv_w, conv_b, wa, ba, wx, bx, lam, w_out):
    n, t, _ = h.shape
    gate_br, x_br = jnp.split(h @ w_in, 2, axis=-1)
    xc, new_buf = causal_conv(x_br, conv_buf, conv_w, conv_b)
    xh = xc.reshape(n, t, N_LRU_HEADS, LRU_BLOCK)
    r = jax.nn.sigmoid((jnp.einsum('bthi,hij->bthj', xh, wa) + ba).astype(jnp.float32)).reshape(n, t, D_RNN)
    ig = jax.nn.sigmoid((jnp.einsum('bthi,hij->bthj', xh, wx) + bx).astype(jnp.float32)).reshape(n, t, D_RNN)
    log_a = -LRU_C * r * jax.nn.softplus(-lam.astype(jnp.float32))
    a = jnp.exp(log_a)
    mult = jnp.sqrt(-jnp.expm1(2.0 * log_a))
    bt = mult * (ig * xc.astype(jnp.float32))
    bt = bt.at[:, 0].add(a[:, 0] * h0.astype(jnp.float32))
    _, hs = lax.associative_scan(_lin_comb, (a, bt), axis=1)
    y = hs.astype(h.dtype) * jax.nn.gelu(gate_br)
    return y @ w_out, new_buf, hs[:, -1].astype(h0.dtype)


def chunk_sgu_mixer(h, w_in, b_in, ln_g, ln_b, ws, bs, w_out):
    n, t, _ = h.shape
    u, v = jnp.split(jax.nn.gelu(h @ w_in + b_in), 2, axis=-1)
    v = layernorm(v, ln_g, ln_b)
    cl = min(t, CHUNK)
    mask = jnp.tril(jnp.ones((cl, cl), dtype=bool))
    w_sp = jnp.where(mask, ws[:, :cl, :cl], 0).astype(v.dtype)
    vc = v.reshape(n, t // cl, cl, N_SG_GROUPS, SG_GROUP)
    mixed = jnp.einsum('gts,bcsgd->bctgd', w_sp, vc) + bs[:, :cl].T[None, None, :, :, None]
    out = u * mixed.reshape(n, t, D_SG)
    return out @ w_out, v


def run_trunk(x, c, conv_state, h_state, ada_w, ada_b, norm_g, lru_w_in, lru_conv_w, lru_conv_b,
              lru_wa, lru_ba, lru_wx, lru_bx, lru_lambda, lru_w_out, sg_w_in, sg_b_in, sg_ln_g,
              sg_ln_b, sg_ws, sg_bs, sg_w_out, mlp_w_up, mlp_w_down):
    convs, hs, vs = [], [], []
    for layer in range(DEPTH):
        sh_m, sc_m, g_m, sh_f, sc_f, g_f = ada_params(c, ada_w[layer], ada_b[layer])
        hin = rmsnorm(x, norm_g[layer, 0]) * (1.0 + sc_m) + sh_m
        j = layer // N_MIXERS
        if layer % N_MIXERS == 0:
            mix, buf, hn = rglru_mixer(hin, conv_state[j], h_state[j], lru_w_in[j], lru_conv_w[j],
                                       lru_conv_b[j], lru_wa[j], lru_ba[j], lru_wx[j], lru_bx[j],
                                       lru_lambda[j], lru_w_out[j])
            convs.append(buf)
            hs.append(hn)
        else:
            mix, v = chunk_sgu_mixer(hin, sg_w_in[j], sg_b_in[j], sg_ln_g[j], sg_ln_b[j],
                                     sg_ws[j], sg_bs[j], sg_w_out[j])
            vs.append(v)
        x = x + g_m * rmsnorm(mix, norm_g[layer, 1])
        hf = rmsnorm(x, norm_g[layer, 2]) * (1.0 + sc_f) + sh_f
        f = jnp.square(jax.nn.relu(hf @ mlp_w_up[layer])) @ mlp_w_down[layer]
        x = x + g_f * rmsnorm(f, norm_g[layer, 3])
    return x, jnp.stack(convs), jnp.stack(hs), jnp.stack(vs)


def setup_inputs(seed: int = 0) -> dict:
    key = jax.random.key(seed)
    ks = iter(jax.random.split(key, 40))
    f32 = jnp.float32

    def nrm(shape, s):
        return jax.random.normal(next(ks), shape, f32) * s

    D = D_MODEL
    NL, NC, H, BS, G = N_LRU_LAYERS, N_SG_LAYERS, N_LRU_HEADS, LRU_BLOCK, N_SG_GROUPS
    a0 = jax.random.uniform(next(ks), (NL, D_RNN), f32, 0.9, 0.999)
    p = a0 ** (1.0 / LRU_C)
    return {
        "x_prompt": nrm((BATCH, SEQ, D), 1.0),
        "x_sample": nrm((DEC_BATCH, DEC_SEQ, D), 1.0),
        "c_prompt": nrm((BATCH, D), 1.0),
        "c_sample": nrm((DEC_BATCH, D), 1.0),
        "state_lru_h": nrm((NL, DEC_BATCH, D_RNN), 0.5),
        "state_lru_conv": nrm((NL, DEC_BATCH, CONV_W - 1, D_RNN), 1.0),
        "ada_w": nrm((DEPTH, D, 6 * D), 0.5 * D ** -0.5),
        "ada_b": nrm((DEPTH, 6 * D), 0.02),
        "norm_g": 1.0 + nrm((DEPTH, 4, D), 0.05),
        "lru_w_in": nrm((NL, D, 2 * D_RNN), D ** -0.5),
        "lru_conv_w": nrm((NL, CONV_W, D_RNN), CONV_W ** -0.5),
        "lru_conv_b": nrm((NL, D_RNN), 0.02),
        "lru_wa": nrm((NL, H, BS, BS), BS ** -0.5),
        "lru_ba": nrm((NL, H, BS), 0.02),
        "lru_wx": nrm((NL, H, BS, BS), BS ** -0.5),
        "lru_bx": nrm((NL, H, BS), 0.02),
        "lru_lambda": jnp.log(p) - jnp.log1p(-p),
        "lru_w_out": nrm((NL, D_RNN, D), D_RNN ** -0.5),
        "sg_w_in": nrm((NC, D, 2 * D_SG), D ** -0.5),
        "sg_b_in": nrm((NC, 2 * D_SG), 0.02),
        "sg_ln_g": 1.0 + nrm((NC, D_SG), 0.05),
        "sg_ln_b": nrm((NC, D_SG), 0.02),
        "sg_ws": nrm((NC, G, CHUNK, CHUNK), CHUNK ** -0.5),
        "sg_bs": 1.0 + nrm((NC, G, CHUNK), 0.1),
        "sg_w_out": nrm((NC, D_SG, D), D_SG ** -0.5),
        "mlp_w_up": nrm((DEPTH, D, D_FF), D ** -0.5),
        "mlp_w_down": nrm((DEPTH, D_FF, D), D_FF ** -0.5),
    }


def reference(x_prompt, x_sample, c_prompt, c_sample, state_lru_h, state_lru_conv, ada_w, ada_b,
              norm_g, lru_w_in, lru_conv_w, lru_conv_b, lru_wa, lru_ba, lru_wx, lru_bx, lru_lambda,
              lru_w_out, sg_w_in, sg_b_in, sg_ln_g, sg_ln_b, sg_ws, sg_bs, sg_w_out, mlp_w_up,
              mlp_w_down):
    b = x_prompt.shape[0]
    zero_conv = jnp.zeros((N_LRU_LAYERS, b, CONV_W - 1, D_RNN), x_prompt.dtype)
    zero_h = jnp.zeros((N_LRU_LAYERS, b, D_RNN), state_lru_h.dtype)
    y_prompt, conv_prompt, h_prompt, _ = run_trunk(
        x_prompt, c_prompt, zero_conv, zero_h, ada_w, ada_b, norm_g, lru_w_in, lru_conv_w,
        lru_conv_b, lru_wa, lru_ba, lru_wx, lru_bx, lru_lambda, lru_w_out, sg_w_in, sg_b_in,
        sg_ln_g, sg_ln_b, sg_ws, sg_bs, sg_w_out, mlp_w_up, mlp_w_down)
    y_sample, conv_sample, h_sample, v_sample = run_trunk(
        x_sample, c_sample, state_lru_conv, state_lru_h, ada_w, ada_b, norm_g, lru_w_in, lru_conv_w,
        lru_conv_b, lru_wa, lru_ba, lru_wx, lru_bx, lru_lambda, lru_w_out, sg_w_in, sg_b_in,
        sg_ln_g, sg_ln_b, sg_ws, sg_bs, sg_w_out, mlp_w_up, mlp_w_down)
    return (y_prompt, y_sample, h_prompt, conv_prompt, h_sample, conv_sample, v_sample)
```

```cpp
#include <hip/hip_runtime.h>
#include <hip/hip_cooperative_groups.h>
#include <cstdio>
namespace cg = cooperative_groups;

#define LAS __attribute__((address_space(3)))
typedef unsigned short bf16_t;
typedef short bf16x8 __attribute__((ext_vector_type(8)));
typedef float f32x4 __attribute__((ext_vector_type(4)));
typedef float f32x2 __attribute__((ext_vector_type(2)));
typedef unsigned u32x4 __attribute__((ext_vector_type(4)));
typedef unsigned u32x2 __attribute__((ext_vector_type(2)));

constexpr int D = 1024, TP = 16384, TSMP = 512, T = TP + TSMP, NSEQ = 136, DR = 1536, DFF = 4096, NMOD = 4 * 6144;
constexpr int LDBIG = 4096, LDY = 1536;
constexpr float EPS = 1e-6f;
constexpr int NTHREADS = 512;
constexpr int LDS_BYTES = 147456;
constexpr int MISC_OFF = LDS_BYTES - 64;
constexpr size_t O_Y = 0, O_HP = (size_t)T * D, O_CP = O_HP + 2 * 8 * DR, O_HS = O_CP + 2 * 8 * 3 * DR, O_CS = O_HS + 2 * 128 * DR, O_VS = O_CS + 2 * 128 * 3 * DR;
constexpr size_t WS_CTL = 0, CTL_BYTES = 65536;
constexpr size_t WS_ADA = WS_CTL + CTL_BYTES;
constexpr size_t WS_LIN = WS_ADA + (size_t)NMOD * D * 2;
constexpr size_t WS_LOUT = WS_LIN + 2 * (size_t)3072 * 1024 * 2;
constexpr size_t WS_SIN = WS_LOUT + 2 * (size_t)1024 * 1536 * 2;
constexpr size_t WS_SOUT = WS_SIN + 2 * (size_t)3072 * 1024 * 2;
constexpr size_t WS_UP = WS_SOUT + 2 * (size_t)1024 * 1536 * 2;
constexpr size_t WS_DN = WS_UP + 4 * (size_t)4096 * 1024 * 2;
constexpr size_t WS_WAT = WS_DN + 4 * (size_t)4096 * 1024 * 2;
constexpr size_t WS_WXT = WS_WAT + (size_t)2 * 16 * 96 * 96 * 2;
constexpr size_t WS_CA = WS_WXT + (size_t)2 * 16 * 96 * 96 * 2;
constexpr size_t WS_MOD = WS_CA + (size_t)256 * 1024 * 2;
constexpr size_t WS_BIG = WS_MOD + (size_t)NSEQ * NMOD * 4;
constexpr size_t WS_Y = WS_BIG + (size_t)T * LDBIG * 2;
constexpr size_t WS_END = WS_Y + (size_t)T * LDY * 2;
constexpr size_t WS_HIN = WS_ADA;

__device__ __forceinline__ unsigned cvt_pk_bf16(float lo, float hi) { unsigned r; asm volatile("v_cvt_pk_bf16_f32 %0, %1, %2" : "=v"(r) : "v"(lo), "v"(hi)); return r; }
__device__ __forceinline__ float bflo(unsigned w) { return __uint_as_float(w << 16); }
__device__ __forceinline__ float bfhi(unsigned w) { return __uint_as_float(w & 0xffff0000u); }
__device__ __forceinline__ float bf2f(bf16_t b) { return __uint_as_float(((unsigned)b) << 16); }
__device__ __forceinline__ float gelu_tanh(float x) { const float z = 0.7978845608028654f * (x + 0.044715f * x * x * x); return x / (1.0f + __expf(-2.0f * z)); }
__device__ __forceinline__ float sigmoidf_(float x) { return 1.0f / (1.0f + __expf(-x)); }
__device__ __forceinline__ float wave_sum(float v) {
#pragma unroll
    for (int o = 32; o > 0; o >>= 1) v += __shfl_xor(v, o);
    return v;
}

namespace pg8 {
constexpr int BM = 256, BK = 64, HALF = 128, HTB = HALF * BK * 2, STAGE_BYTES = 8 * HTB, NXCD = 8, WGM = 8;
__host__ __device__ __forceinline__ int lds_byte(int r, int c) { const int st = (r >> 4) * 2 + (c >> 5), rr = r & 15, cc = c & 31, ob = rr * 64 + cc * 2; return st * 1024 + (ob ^ (((ob >> 9) & 1) << 5)); }
__host__ __device__ __forceinline__ void stage_rc(int b, int& R, int& C) { const int st = b / 1024, sb = b % 1024, swz = sb ^ (((sb >> 9) & 1) << 5); R = (st >> 1) * 16 + swz / 64; C = (st & 1) * 32 + (swz % 64) / 2; }
__host__ __device__ __forceinline__ int perm32(int rho) { const int n = rho >> 4, i = rho & 15; return 8 * (i >> 2) + 4 * n + (i & 3); }

struct Unit { int pm, pn; };
struct Gemm { const bf16_t* A; const bf16_t* Bt; int M, N, K; };

struct StaticOrder {
    int nM, nN, nwg, G, c;
    __device__ void init(int M, int N, int G_, int c_) { nM = M / BM; nN = N / BM; nwg = nM * nN; G = G_; c = c_; }
    __device__ bool next(int i, Unit& u) const {
        const long L = (long)i * G + c; if (L >= nwg) return false;
        int wgid = (int)L; { const int q = nwg / NXCD, r = nwg % NXCD, xcd = wgid % NXCD, off = wgid / NXCD; wgid = (xcd < r ? xcd * (q + 1) : r * (q + 1) + (xcd - r) * q) + off; }
        const int nig = WGM * nN, gid = wgid / nig, fm = gid * WGM, gsz = (nM - fm) < WGM ? (nM - fm) : WGM;
        u.pm = fm + ((wgid % nig) % gsz); u.pn = (wgid % nig) / gsz; return true;
    }
    __device__ __forceinline__ void a_ready(const Unit&) const {}
    __device__ __forceinline__ void done(const Unit&) const {}
};

struct EpiU {
    int mode; bool perm; bf16_t* O; float* C; int ldc; const float* bias; int nrows;
    __device__ __forceinline__ void operator()(const f32x4 (&acc)[2][2][4][2], const Unit& u, int wr, int wc, int fr, int fq) const {
        if (mode == 3) {
            const int row0 = u.pm * BM + wr * 64 + fr, col0 = u.pn * BM + wc * 32 + 4 * fq;
#pragma unroll
            for (int ai = 0; ai < 2; ++ai)
#pragma unroll
                for (int m = 0; m < 4; ++m) { const int row = row0 + ai * HALF + m * 16; if (row < nrows) { float* rowp = C + (size_t)row * ldc + col0;
#pragma unroll
                    for (int bj = 0; bj < 2; ++bj)
#pragma unroll
                        for (int n = 0; n < 2; ++n) *(f32x4*)(rowp + bj * HALF + n * 16) = acc[ai][bj][m][n] + *(const f32x4*)(bias + col0 + bj * HALF + n * 16); } }
            return;
        }
        const int row0 = u.pm * BM + wr * 64 + fr, col0 = u.pn * BM + wc * 32 + 8 * fq;
#pragma unroll
        for (int ai = 0; ai < 2; ++ai)
#pragma unroll
            for (int m = 0; m < 4; ++m) { bf16_t* rowp = O + (size_t)(row0 + ai * HALF + m * 16) * ldc + col0;
#pragma unroll
                for (int bj = 0; bj < 2; ++bj) { f32x4 v0 = acc[ai][bj][m][0], v1 = acc[ai][bj][m][1];
                    if (mode == 1) { v0 += *(const f32x4*)(bias + col0 + bj * HALF); v1 += *(const f32x4*)(bias + col0 + bj * HALF + 4);
#pragma unroll
                        for (int j = 0; j < 4; ++j) { v0[j] = gelu_tanh(v0[j]); v1[j] = gelu_tanh(v1[j]); } }
                    else if (mode == 2) {
#pragma unroll
                        for (int j = 0; j < 4; ++j) { const float a = fmaxf(v0[j], 0.f), b = fmaxf(v1[j], 0.f); v0[j] = a * a; v1[j] = b * b; } }
                    u32x4 w; w.x = cvt_pk_bf16(v0[0], v0[1]); w.y = cvt_pk_bf16(v0[2], v0[3]); w.z = cvt_pk_bf16(v1[0], v1[1]); w.w = cvt_pk_bf16(v1[2], v1[3]);
                    *(u32x4*)(rowp + bj * HALF) = w; } }
    }
};

template <class Epi, class Sched>
__device__ __forceinline__ void gemm_phase(LAS unsigned char* lds, const Gemm g, const Sched& S, const Epi& E) {
    int tid_ = threadIdx.x; asm volatile("" : "+v"(tid_));
    const int tid = tid_, wid = __builtin_amdgcn_readfirstlane(tid >> 6), lane = tid & 63, wr = wid >> 2, wc = wid & 3, fr = lane & 15, fq = lane >> 4;
    const int K = g.K, nt = K / BK;
    unsigned voffA[2], voffB[2];
#pragma unroll
    for (int i = 0; i < 2; ++i) { int R, C; stage_rc(tid * 16 + i * 8192, R, C); const int Rb = E.perm ? ((R & ~31) + perm32(R & 31)) : R;
        voffA[i] = (unsigned)(R * K + C) * 2u; voffB[i] = (unsigned)(Rb * K + C) * 2u; }
    const size_t kstep = (size_t)(BK * 2);
    const size_t hstep = (size_t)HALF * K * 2;
    const size_t tstep = 2 * hstep;
    const unsigned ldsw = (unsigned)wid * 1024u;
    const int aoff = lds_byte(wr * 64 + fr, fq * 8), boff = lds_byte(wc * 32 + fr, fq * 8);
#define PG8_SA(b, h) (((b) * 2 + (h)) * HTB)
#define PG8_SB(b, h) ((4 + (b) * 2 + (h)) * HTB)
#define PG8_STAGE(bufoff, gbase, voff) do { _Pragma("unroll") for (int _i = 0; _i < 2; ++_i) \
        __builtin_amdgcn_global_load_lds((const unsigned*)((const char*)(gbase) + (voff)[_i]), (LAS unsigned*)(lds + (bufoff) + ldsw + _i * 8192), 16, 0, 0); } while (0)
#define PG8_LDA(dst, b, h) do { _Pragma("unroll") for (int m = 0; m < 4; ++m) _Pragma("unroll") for (int k = 0; k < 2; ++k) dst[m][k] = *(const LAS bf16x8*)(lds + PG8_SA(b, h) + aoff + m * 2048 + k * 1024); } while (0)
#define PG8_LDB(dst, b, h) do { _Pragma("unroll") for (int n = 0; n < 2; ++n) _Pragma("unroll") for (int k = 0; k < 2; ++k) dst[n][k] = *(const LAS bf16x8*)(lds + PG8_SB(b, h) + boff + n * 2048 + k * 1024); } while (0)
#define PG8_MMA(ai, bj, At, Bt) do { __builtin_amdgcn_s_setprio(1); _Pragma("unroll") for (int m = 0; m < 4; ++m) _Pragma("unroll") for (int n = 0; n < 2; ++n) _Pragma("unroll") for (int k = 0; k < 2; ++k) \
        acc[ai][bj][m][n] = __builtin_amdgcn_mfma_f32_16x16x32_bf16(Bt[n][k], At[m][k], acc[ai][bj][m][n], 0, 0, 0); __builtin_amdgcn_s_setprio(0); } while (0)
#define PG8_WAIT_V(n) asm volatile("s_waitcnt vmcnt(" #n ")" ::: "memory")
#define PG8_WAIT_L(n) asm volatile("s_waitcnt lgkmcnt(" #n ")" ::: "memory")
#define PG8_BAR __builtin_amdgcn_s_barrier()
#define PG8_SCHED __builtin_amdgcn_sched_barrier(0)
    Unit cur, nxt; int ui = 0;
    if (!S.next(0, cur)) return;
    f32x4 acc[2][2][4][2];
#pragma unroll
    for (int a = 0; a < 2; ++a)
#pragma unroll
        for (int b = 0; b < 2; ++b)
#pragma unroll
            for (int m = 0; m < 4; ++m)
#pragma unroll
                for (int n = 0; n < 2; ++n) acc[a][b][m][n] = (f32x4){0.f, 0.f, 0.f, 0.f};
    bf16x8 At[4][2], B0[2][2], B1[2][2];
    const char* cA = (const char*)g.A + (size_t)cur.pm * tstep; const char* cB = (const char*)g.Bt + (size_t)cur.pn * tstep;
    S.a_ready(cur);
    PG8_STAGE(PG8_SB(0, 0), cB, voffB); PG8_STAGE(PG8_SB(0, 1), cB + hstep, voffB); PG8_STAGE(PG8_SA(0, 0), cA, voffA); PG8_STAGE(PG8_SA(0, 1), cA + hstep, voffA);
    if (wr == 1) PG8_BAR;
    PG8_WAIT_V(2); PG8_BAR;
    PG8_STAGE(PG8_SB(1, 0), cB + kstep, voffB); PG8_STAGE(PG8_SA(1, 0), cA + kstep, voffA); PG8_STAGE(PG8_SB(1, 1), cB + hstep + kstep, voffB);
    PG8_WAIT_V(6); PG8_BAR;
    for (;;) {
        const bool has_next = S.next(ui + 1, nxt);
        const char* nA = has_next ? (const char*)g.A + (size_t)nxt.pm * tstep : cA; const char* nB = has_next ? (const char*)g.Bt + (size_t)nxt.pn * tstep : cB;
        for (int t = 0; t < nt; t += 2) {
            const bool last = (t == nt - 2);
            const char* a1 = cA + (size_t)(t + 1) * kstep;
            const char* a2 = last ? nA : cA + (size_t)(t + 2) * kstep; const char* b2 = last ? nB : cB + (size_t)(t + 2) * kstep;
            const char* a3 = a2 + kstep; const char* b3 = b2 + kstep;
            if (last && has_next) S.a_ready(nxt);
            PG8_LDB(B0, 0, 0); PG8_LDB(B1, 0, 1); PG8_SCHED; PG8_LDA(At, 0, 0); PG8_STAGE(PG8_SA(1, 1), a1 + hstep, voffA);
            PG8_WAIT_V(8); PG8_WAIT_L(0); PG8_BAR; PG8_MMA(0, 0, At, B0); PG8_MMA(0, 1, At, B1); PG8_BAR; PG8_SCHED;
            PG8_LDA(At, 0, 1); PG8_STAGE(PG8_SB(0, 0), b2, voffB); PG8_STAGE(PG8_SB(0, 1), b2 + hstep, voffB); PG8_STAGE(PG8_SA(0, 0), a2, voffA);
            PG8_WAIT_V(8); PG8_WAIT_L(0); PG8_BAR; PG8_MMA(1, 0, At, B0); PG8_MMA(1, 1, At, B1); PG8_BAR; PG8_SCHED;
            PG8_LDB(B0, 1, 0); PG8_LDB(B1, 1, 1); PG8_SCHED; PG8_LDA(At, 1, 0); PG8_STAGE(PG8_SA(0, 1), a2 + hstep, voffA);
            PG8_WAIT_V(8); PG8_WAIT_L(0); PG8_BAR; PG8_MMA(0, 0, At, B0); PG8_MMA(0, 1, At, B1); PG8_BAR; PG8_SCHED;
            PG8_LDA(At, 1, 1); PG8_STAGE(PG8_SB(1, 0), b3, voffB); PG8_STAGE(PG8_SB(1, 1), b3 + hstep, voffB); PG8_STAGE(PG8_SA(1, 0), a3, voffA);
            PG8_WAIT_V(8); PG8_WAIT_L(0); PG8_BAR; PG8_MMA(1, 0, At, B0); PG8_MMA(1, 1, At, B1); PG8_BAR; PG8_SCHED;
        }
        if (wr == 0) PG8_BAR;
        E(acc, cur, wr, wc, fr, fq); S.done(cur);
        if (!has_next) break;
#pragma unroll
        for (int a = 0; a < 2; ++a)
#pragma unroll
            for (int b = 0; b < 2; ++b)
#pragma unroll
                for (int m = 0; m < 4; ++m)
#pragma unroll
                    for (int n = 0; n < 2; ++n) acc[a][b][m][n] = (f32x4){0.f, 0.f, 0.f, 0.f};
        cur = nxt; cA = nA; cB = nB; ++ui;
        if (wr == 1) PG8_BAR;
    }
    PG8_WAIT_V(0);
    PG8_BAR;
#undef PG8_SA
#undef PG8_SB
#undef PG8_STAGE
#undef PG8_LDA
#undef PG8_LDB
#undef PG8_MMA
#undef PG8_WAIT_V
#undef PG8_WAIT_L
#undef PG8_BAR
#undef PG8_SCHED
}
}

#define XB_TMO      128
#define XB_XCNT(j)  (256  + 64 * (j))
#define XB_XSUB(j)  (1280 + 64 * (j))
#define XB_XGEN(j)  (2304 + 64 * (j))
#define XB_TOP      3328
#define XB_TOPGEN   3392
#define XCD_BAR_WORDS 3456
#define XB_SPIN_CAP (1u << 20)
__device__ __forceinline__ unsigned xb_ld(unsigned* p)              { return __hip_atomic_load(p, __ATOMIC_RELAXED, __HIP_MEMORY_SCOPE_AGENT); }
__device__ __forceinline__ unsigned xb_add(unsigned* p, unsigned v) { return __hip_atomic_fetch_add(p, v, __ATOMIC_RELAXED, __HIP_MEMORY_SCOPE_AGENT); }
__device__ __forceinline__ unsigned xb_xcc_id() { return (unsigned)__builtin_amdgcn_s_getreg((3 << 11) | 20) & 0xFu; }
#define XB_SPIN(cond, bar) do { unsigned _sp = 0; while (cond) { __builtin_amdgcn_s_sleep(1); \
    if ((++_sp & 255u) == 0u) { if (xb_ld(&(bar)[XB_TMO])) break; if (_sp > XB_SPIN_CAP) { atomicAdd(&(bar)[XB_TMO], 1u); break; } } } } while (0)
struct XcdBarrier { unsigned* bar; unsigned x; volatile LAS unsigned* st; };
__device__ __forceinline__ XcdBarrier xcd_barrier_post(unsigned* bar, volatile LAS unsigned* st) {
    XcdBarrier b; b.bar = bar; b.x = xb_xcc_id(); b.st = st;
    if (threadIdx.x == 0) (void)xb_add(&bar[XB_XCNT(b.x)], 1u);
    return b;
}
__device__ __forceinline__ void xcd_barrier_complete(unsigned* bar, unsigned x, unsigned& nloc, unsigned& nx) {
    const unsigned G = gridDim.x * gridDim.y * gridDim.z;
    unsigned sum, cnt, mine, sp = 0u;
    for (;;) {
        sum = 0u; cnt = 0u; mine = 0u;
#pragma unroll
        for (unsigned j = 0; j < 16; ++j) { const unsigned c = xb_ld(&bar[XB_XCNT(j)]); sum += c; cnt += (c > 0u) ? 1u : 0u; mine = (j == x) ? c : mine; }
        if (sum == G) break;
        __builtin_amdgcn_s_sleep(1);
        if ((++sp & 255u) == 0u) { if (xb_ld(&bar[XB_TMO])) break; if (sp > XB_SPIN_CAP) { atomicAdd(&bar[XB_TMO], 1u); break; } }
    }
    nloc = mine > 0u ? mine : 1u; nx = cnt > 0u ? cnt : 1u;
}
__device__ __forceinline__ void xcd_barrier(const XcdBarrier& b) {
    asm volatile("s_waitcnt vmcnt(0)" ::: "memory");
    __syncthreads();
    if (threadIdx.x == 0) {
        unsigned* bar = b.bar; unsigned bx = b.x;
        asm volatile("" : "+s"(bar), "+s"(bx));
        __builtin_amdgcn_s_waitcnt(0);
        unsigned nloc = b.st[0], nx = b.st[1];
        if (nloc == 0u) { xcd_barrier_complete(bar, bx, nloc, nx); b.st[0] = nloc; b.st[1] = nx; }
        const unsigned old = xb_add(&bar[XB_XSUB(bx)], 1u);
        const unsigned gen = old / nloc;
        if (old + 1u == (gen + 1u) * nloc) {
            __builtin_amdgcn_fence(__ATOMIC_RELEASE, "agent");
            asm volatile("s_waitcnt vmcnt(0)" ::: "memory");
            const unsigned og = xb_add(&bar[XB_TOP], 1u);
            const unsigned tg = og / nx;
            if (og + 1u == (tg + 1u) * nx) xb_add(&bar[XB_TOPGEN], 1u);
            else XB_SPIN(xb_ld(&bar[XB_TOPGEN]) == tg, bar);
            __builtin_amdgcn_fence(__ATOMIC_ACQUIRE, "agent");
            xb_add(&bar[XB_XGEN(bx)], 1u);
            asm volatile("s_waitcnt vmcnt(0)" ::: "memory");
        } else {
            XB_SPIN(xb_ld(&bar[XB_XGEN(bx)]) == gen, bar);
            __builtin_amdgcn_fence(__ATOMIC_ACQUIRE, "agent");
            asm volatile("s_waitcnt vmcnt(0)" ::: "memory");
        }
    }
    __syncthreads();
}

struct Params { const float* in[27]; float* out; unsigned char* ws; };
enum { I_XP = 0, I_XS, I_CP, I_CS, I_SH, I_SC, I_ADAW, I_ADAB, I_NG, I_LWIN, I_LCW, I_LCB, I_LWA, I_LBA, I_LWX, I_LBX, I_LLAM, I_LWOUT,
       I_SWIN, I_SBIN, I_SLNG, I_SLNB, I_SWS, I_SBS, I_SWOUT, I_UP, I_DN };

__device__ void convert_transpose(LAS unsigned char* lds, const float* __restrict__ src, bf16_t* __restrict__ dst, int K, int N, int nmat, int G, int bid) {
    LAS unsigned* Tt = (LAS unsigned*)lds;
    int tid_ = threadIdx.x; asm volatile("" : "+v"(tid_));
    const int tk = K / 128, tn = N / 64, per = tk * tn, total = nmat * per, tid = tid_;
    for (int t = bid; t < total; t += G) {
        const int mi = t / per, r = t % per, kt = r / tn, ntl = r % tn;
        const float* s = src + (size_t)mi * K * N + (size_t)(kt * 128) * N + ntl * 64;
        bf16_t* d = dst + (size_t)mi * N * K + (size_t)(ntl * 64) * K + kt * 128;
#pragma unroll
        for (int i = 0; i < 2; ++i) {
            const int idx = i * 512 + tid, kp = idx >> 4, nq = idx & 15;
            const f32x4 a = *(const f32x4*)(s + (size_t)(2 * kp) * N + nq * 4);
            const f32x4 b = *(const f32x4*)(s + (size_t)(2 * kp + 1) * N + nq * 4);
#pragma unroll
            for (int j = 0; j < 4; ++j) Tt[(nq * 4 + j) * 65 + kp] = cvt_pk_bf16(a[j], b[j]);
        }
        __syncthreads();
#pragma unroll
        for (int i = 0; i < 2; ++i) {
            const int idx = i * 512 + tid, n = idx >> 4, q = idx & 15;
            u32x4 w; w.x = Tt[n * 65 + q * 4 + 0]; w.y = Tt[n * 65 + q * 4 + 1]; w.z = Tt[n * 65 + q * 4 + 2]; w.w = Tt[n * 65 + q * 4 + 3];
            *(u32x4*)(d + (size_t)n * K + q * 8) = w;
        }
        __syncthreads();
    }
}

__device__ void rowwise_phase(const float* xinP, const float* xinS, float* xout, const bf16_t* res, int ldr, const float* gA, const float* mod, int gate_off,
                              const float* gB, int sc_off, int sh_off, bf16_t* hout, int G, int bid) {
    int tid_ = threadIdx.x; asm volatile("" : "+v"(tid_));
    const int lane = tid_ & 63, wave = tid_ >> 6;
    for (int rb = bid; rb < T / 8; rb += G) {
        const int row = rb * 8 + wave;
        const float* xr = row < TP ? xinP + (size_t)row * D : xinS + (size_t)(row - TP) * D;
        const int s = row < TP ? (row >> 11) : 8 + ((row - TP) >> 2);
        const float* mr = mod + (size_t)s * NMOD;
        f32x4 x[4];
#pragma unroll
        for (int i = 0; i < 4; ++i) x[i] = *(const f32x4*)(xr + (i * 64 + lane) * 4);
        if (res) {
            f32x4 r[4]; float ss = 0.f;
#pragma unroll
            for (int i = 0; i < 4; ++i) { const u32x2 w = *(const u32x2*)(res + (size_t)row * ldr + (i * 64 + lane) * 4);
                r[i] = (f32x4){bflo(w.x), bfhi(w.x), bflo(w.y), bfhi(w.y)}; ss += r[i][0] * r[i][0] + r[i][1] * r[i][1] + r[i][2] * r[i][2] + r[i][3] * r[i][3]; }
            ss = wave_sum(ss); const float rs = rsqrtf(ss * (1.0f / D) + EPS);
#pragma unroll
            for (int i = 0; i < 4; ++i) { const int c = (i * 64 + lane) * 4; const f32x4 ga = *(const f32x4*)(gA + c), gt = *(const f32x4*)(mr + gate_off + c);
                x[i] += gt * ((r[i] * rs) * ga); }
        }
        float* xo = xout + (size_t)row * D;
#pragma unroll
        for (int i = 0; i < 4; ++i) *(f32x4*)(xo + (i * 64 + lane) * 4) = x[i];
        if (hout) {
            float ss = 0.f;
#pragma unroll
            for (int i = 0; i < 4; ++i) ss += x[i][0] * x[i][0] + x[i][1] * x[i][1] + x[i][2] * x[i][2] + x[i][3] * x[i][3];
            ss = wave_sum(ss); const float rs = rsqrtf(ss * (1.0f / D) + EPS);
#pragma unroll
            for (int i = 0; i < 4; ++i) { const int c = (i * 64 + lane) * 4;
                const f32x4 gb = *(const f32x4*)(gB + c), sc = *(const f32x4*)(mr + sc_off + c), sh = *(const f32x4*)(mr + sh_off + c);
                const f32x4 h = ((x[i] * rs) * gb) * (sc + 1.0f) + sh;
                u32x2 w; w.x = cvt_pk_bf16(h[0], h[1]); w.y = cvt_pk_bf16(h[2], h[3]);
                *(u32x2*)(hout + (size_t)row * D + c) = w; }
        }
    }
}

constexpr int L_XB = 0;
constexpr int L_WA = 53888;
constexpr int L_WX = L_WA + 19968;
constexpr int L_HS = L_WX + 19968;
constexpr int L_CW = L_HS + 36864;
constexpr int L_CB = L_CW + 1536;
constexpr int L_BA = L_CB + 384;
constexpr int L_BX = L_BA + 384;
constexpr int L_SP = L_BX + 384;
constexpr int L_WT = L_SP + 384;
constexpr int L_HC = L_WT + 6144;
constexpr int L_LRU_END = L_HC + 768;
static_assert(L_LRU_END <= MISC_OFF, "LRU LDS");

template <bool SAMPLE>
__device__ __forceinline__ void lru_tile(LAS unsigned char* lds, const Params& P, int jl, int h, int row0, int seq0  ,
                                         bool first_tile, bool last_tile, int hc_cur) {
    int tid_ = threadIdx.x; asm volatile("" : "+v"(tid_));
    const int tid = tid_, lane = tid & 63, w = tid >> 6, fr = lane & 15, fq = lane >> 4;
    const bf16_t* BIG = (const bf16_t*)(P.ws + WS_BIG);
    bf16_t* Y = (bf16_t*)(P.ws + WS_Y);
    LAS bf16_t* XB = (LAS bf16_t*)(lds + L_XB);
    LAS bf16_t* HS = (LAS bf16_t*)(lds + L_HS);
    LAS float* CW = (LAS float*)(lds + L_CW); LAS float* CB = (LAS float*)(lds + L_CB); LAS float* BA = (LAS float*)(lds + L_BA);
    LAS float* BX = (LAS float*)(lds + L_BX); LAS float* SP = (LAS float*)(lds + L_SP); LAS float* WT = (LAS float*)(lds + L_WT); LAS float* HC = (LAS float*)(lds + L_HC);
    for (int idx = tid; idx < 259 * 12; idx += NTHREADS) {
        const int r = idx / 12, q = idx % 12; u32x4 v = (u32x4){0u, 0u, 0u, 0u};
        if (r >= 3 || (!SAMPLE && !first_tile)) v = *(const u32x4*)(BIG + (size_t)(row0 - 3 + r) * LDBIG + DR + 96 * h + 8 * q);
        *(LAS u32x4*)(XB + r * 104 + 8 * q) = v;
    }
    if (SAMPLE) {
        const float* sc = P.in[I_SC] + ((size_t)jl * 128 + seq0) * 3 * DR + 96 * h;
        for (int idx = tid; idx < 64 * 3 * 24; idx += NTHREADS) { const int qi = idx / 24, c4 = idx % 24; const f32x4 v = *(const f32x4*)(sc + (size_t)qi * DR + c4 * 4);
            u32x2 wv; wv.x = cvt_pk_bf16(v[0], v[1]); wv.y = cvt_pk_bf16(v[2], v[3]); *(LAS u32x2*)(HS + qi * 96 + c4 * 4) = wv; }
    }
    __syncthreads();
    f32x4 accA[2][6], accX[2][6];
#pragma unroll
    for (int rt = 0; rt < 2; ++rt)
#pragma unroll
        for (int ct = 0; ct < 6; ++ct) { accA[rt][ct] = (f32x4){0.f, 0.f, 0.f, 0.f}; accX[rt][ct] = (f32x4){0.f, 0.f, 0.f, 0.f}; }
#pragma unroll
    for (int kk = 0; kk < 3; ++kk) {
        const int c0 = 32 * kk + 8 * fq;
        bf16x8 af[2];
#pragma unroll
        for (int rt = 0; rt < 2; ++rt) {
            const int r = 32 * w + 16 * rt + fr;
            float v[8];
#pragma unroll
            for (int i = 0; i < 8; ++i) v[i] = CB[c0 + i];
#pragma unroll
            for (int k = 0; k < 4; ++k) {
                u32x4 xv;
                if (SAMPLE && ((r & 3) + k < 3)) xv = *(const LAS u32x4*)(HS + ((r >> 2) * 3 + (r & 3) + k) * 96 + c0);
                else xv = *(const LAS u32x4*)(XB + (r + k) * 104 + c0);
#pragma unroll
                for (int i = 0; i < 4; ++i) { v[2 * i] += CW[k * 96 + c0 + 2 * i] * bflo(xv[i]); v[2 * i + 1] += CW[k * 96 + c0 + 2 * i + 1] * bfhi(xv[i]); }
            }
            u32x4 pk; pk.x = cvt_pk_bf16(v[0], v[1]); pk.y = cvt_pk_bf16(v[2], v[3]); pk.z = cvt_pk_bf16(v[4], v[5]); pk.w = cvt_pk_bf16(v[6], v[7]);
            af[rt] = __builtin_bit_cast(bf16x8, pk);
        }
#pragma unroll
        for (int ct = 0; ct < 6; ++ct) {
            const bf16x8 ba = *(const LAS bf16x8*)(lds + L_WA + ((16 * ct + fr) * 104 + 32 * kk + 8 * fq) * 2);
            const bf16x8 bx = *(const LAS bf16x8*)(lds + L_WX + ((16 * ct + fr) * 104 + 32 * kk + 8 * fq) * 2);
#pragma unroll
            for (int rt = 0; rt < 2; ++rt) {
                accA[rt][ct] = __builtin_amdgcn_mfma_f32_16x16x32_bf16(af[rt], ba, accA[rt][ct], 0, 0, 0);
                accX[rt][ct] = __builtin_amdgcn_mfma_f32_16x16x32_bf16(af[rt], bx, accX[rt][ct], 0, 0, 0);
            }
        }
    }
    float EA[2][6], EB[2][6];
#pragma unroll
    for (int ct = 0; ct < 6; ++ct) {
        const int j = 16 * ct + fr;
        const float cb = CB[j], cw0 = CW[j], cw1 = CW[96 + j], cw2 = CW[192 + j], cw3 = CW[288 + j], ba = BA[j], bx = BX[j], sp = SP[j];
        float TA = 1.f, TB = 0.f;
#pragma unroll
        for (int rt = 0; rt < 2; ++rt) {
            const int tb = 32 * w + 16 * rt + 4 * fq;
            float xs[7];
#pragma unroll
            for (int i = 0; i < 7; ++i) xs[i] = (SAMPLE && i < 3) ? bf2f(HS[((tb >> 2) * 3 + i) * 96 + j]) : bf2f(XB[(tb + i) * 104 + j]);
            float pa = 1.f, pb = 0.f;
#pragma unroll
            for (int e = 0; e < 4; ++e) {
                const float xc = cb + cw0 * xs[e] + cw1 * xs[e + 1] + cw2 * xs[e + 2] + cw3 * xs[e + 3];
                const float rg = sigmoidf_(accA[rt][ct][e] + ba), ig = sigmoidf_(accX[rt][ct][e] + bx);
                const float la = -8.0f * rg * sp;
                const float a = __expf(la), mult = sqrtf(fmaxf(-expm1f(2.0f * la), 0.f));
                const float bt = mult * (ig * xc);
                pb = a * pb + bt; pa = a * pa;
                accA[rt][ct][e] = pa; accX[rt][ct][e] = pb;
            }
            if (!SAMPLE) {
                float ea = 1.f, eb = 0.f, ta = 1.f, tbv = 0.f;
#pragma unroll
                for (int g = 0; g < 4; ++g) {
                    const float ga = __shfl(pa, fr + 16 * g), gb = __shfl(pb, fr + 16 * g);
                    if (g < fq) { eb = ga * eb + gb; ea = ga * ea; }
                    tbv = ga * tbv + gb; ta = ga * ta;
                }
                EA[rt][ct] = ea * TA; EB[rt][ct] = ea * TB + eb;
                TB = ta * TB + tbv; TA = ta * TA;
            }
        }
        if (!SAMPLE && fq == 0) { WT[(w * 96 + j) * 2] = TA; WT[(w * 96 + j) * 2 + 1] = TB; }
        asm volatile("" ::: "memory");
    }
    if (!SAMPLE) __syncthreads();
    float* out = P.out;
#pragma unroll
    for (int ct = 0; ct < 6; ++ct) {
        const int j = 16 * ct + fr, ch = 96 * h + j;
        float hin;
        if (SAMPLE) hin = 0.f;
        else { hin = HC[hc_cur * 96 + j]; for (int ww = 0; ww < w; ++ww) hin = WT[(ww * 96 + j) * 2] * hin + WT[(ww * 96 + j) * 2 + 1]; }
#pragma unroll
        for (int rt = 0; rt < 2; ++rt) {
            const int tb = 32 * w + 16 * rt + 4 * fq;
            float hx;
            if (SAMPLE) hx = P.in[I_SH][((size_t)jl * 128 + seq0 + (tb >> 2)) * DR + ch];
            else hx = EA[rt][ct] * hin + EB[rt][ct];
            float hl = 0.f;
#pragma unroll
            for (int e = 0; e < 4; ++e) {
                const size_t row = (size_t)row0 + tb + e;
                const float hv = accA[rt][ct][e] * hx + accX[rt][ct][e];
                const float gt = bf2f(BIG[row * LDBIG + ch]);
                const unsigned pk = cvt_pk_bf16(hv * gelu_tanh(gt), 0.f);
                Y[row * LDY + ch] = (bf16_t)(pk & 0xffffu);
                hl = hv;
            }
            if (SAMPLE) out[O_HS + ((size_t)jl * 128 + seq0 + (tb >> 2)) * DR + ch] = hl;
            asm volatile("" ::: "memory");
        }
    }
    if (!SAMPLE) {
        if (tid < 96) { float hv = HC[hc_cur * 96 + tid];
            for (int ww = 0; ww < 8; ++ww) hv = WT[(ww * 96 + tid) * 2] * hv + WT[(ww * 96 + tid) * 2 + 1];
            HC[(hc_cur ^ 1) * 96 + tid] = hv;
            if (last_tile) out[O_HP + ((size_t)jl * 8 + seq0) * DR + 96 * h + tid] = hv; }
        if (last_tile) for (int idx = tid; idx < 3 * 96; idx += NTHREADS) { const int k = idx / 96, c = idx % 96;
            out[O_CP + (((size_t)jl * 8 + seq0) * 3 + k) * DR + 96 * h + c] = bf2f(XB[(3 + 253 + k) * 104 + c]); }
    } else {
        for (int idx = tid; idx < 64 * 3 * 96; idx += NTHREADS) { const int q = idx / 288, k = (idx / 96) % 3, c = idx % 96;
            out[O_CS + (((size_t)jl * 128 + seq0 + q) * 3 + k) * DR + 96 * h + c] = bf2f(XB[(3 + 4 * q + 1 + k) * 104 + c]); }
    }
    __syncthreads();
}

__device__ void lru_core_phase(LAS unsigned char* lds, const Params& P, int jl, int G, int bid) {
    int tid_ = threadIdx.x; asm volatile("" : "+v"(tid_));
    const int tid0 = tid_;
    const bf16_t* WAT = (const bf16_t*)(P.ws + WS_WAT); const bf16_t* WXT = (const bf16_t*)(P.ws + WS_WXT);
    for (int it = bid; it < 160; it += G) {
        const bool sample = it >= 128;
        const int h = sample ? (it - 128) % 16 : it % 16, b = sample ? (it - 128) / 16 : it / 16;
        int tid = tid0; asm volatile("" : "+v"(tid));
        for (int idx = tid; idx < 96 * 12; idx += NTHREADS) { const int j = idx / 12, q = idx % 12;
            *(LAS u32x4*)(lds + L_WA + (j * 104 + 8 * q) * 2) = *(const u32x4*)(WAT + ((size_t)(jl * 16 + h) * 96 + j) * 96 + 8 * q);
            *(LAS u32x4*)(lds + L_WX + (j * 104 + 8 * q) * 2) = *(const u32x4*)(WXT + ((size_t)(jl * 16 + h) * 96 + j) * 96 + 8 * q); }
        if (tid < 96) { const int ch = 96 * h + tid;
            LAS float* CW = (LAS float*)(lds + L_CW);
            for (int k = 0; k < 4; ++k) CW[k * 96 + tid] = P.in[I_LCW][((size_t)jl * 4 + k) * DR + ch];
            ((LAS float*)(lds + L_CB))[tid] = P.in[I_LCB][(size_t)jl * DR + ch];
            ((LAS float*)(lds + L_BA))[tid] = P.in[I_LBA][(size_t)jl * DR + ch];
            ((LAS float*)(lds + L_BX))[tid] = P.in[I_LBX][(size_t)jl * DR + ch];
            ((LAS float*)(lds + L_SP))[tid] = log1pf(__expf(-P.in[I_LLAM][(size_t)jl * DR + ch]));
            ((LAS float*)(lds + L_HC))[tid] = 0.f; }
        __syncthreads();
        if (sample) lru_tile<true>(lds, P, jl, h, TP + 256 * b, 64 * b, true, true, 0);
        else for (int ti = 0; ti < 8; ++ti) lru_tile<false>(lds, P, jl, h, b * 2048 + 256 * ti, b, ti == 0, ti == 7, ti & 1);
    }
}

constexpr int S_ST = 0;
constexpr int S_VT = 1024;
constexpr int S_WS = S_VT + 96 * 136 * 2;
__device__ void sgu_core_phase(LAS unsigned char* lds, const Params& P, int jl, int G, int bid) {
    int tid_ = threadIdx.x; asm volatile("" : "+v"(tid_));
    const int tid = tid_, lane = tid & 63, w = tid >> 6, fr = lane & 15, fq = lane >> 4;
    const bf16_t* BIG = (const bf16_t*)(P.ws + WS_BIG);
    bf16_t* Y = (bf16_t*)(P.ws + WS_Y);
    const float* lng = P.in[I_SLNG] + (size_t)jl * DR; const float* lnb = P.in[I_SLNB] + (size_t)jl * DR;
    const float* wsp = P.in[I_SWS] + (size_t)jl * 16 * 128 * 128; const float* bsp = P.in[I_SBS] + (size_t)jl * 16 * 128;
    LAS float* ST = (LAS float*)(lds + S_ST); LAS bf16_t* VT = (LAS bf16_t*)(lds + S_VT); LAS bf16_t* WS = (LAS bf16_t*)(lds + S_WS);
    for (int it = bid; it < 16 + 256; it += G) {
        if (it < 16) {
            const int sq = it * 8 + w; const size_t row0 = (size_t)TP + 4 * sq;
            float mean[4], rstd[4];
#pragma unroll
            for (int t = 0; t < 4; ++t) {
                float v[24]; float s = 0.f;
#pragma unroll
                for (int i = 0; i < 3; ++i) { const u32x4 x = *(const u32x4*)(BIG + (row0 + t) * LDBIG + DR + (i * 64 + lane) * 8);
#pragma unroll
                    for (int k = 0; k < 4; ++k) { v[i * 8 + 2 * k] = bflo(x[k]); v[i * 8 + 2 * k + 1] = bfhi(x[k]); s += v[i * 8 + 2 * k] + v[i * 8 + 2 * k + 1]; } }
                s = wave_sum(s); const float m = s * (1.0f / DR); float q = 0.f;
#pragma unroll
                for (int k = 0; k < 24; ++k) { const float d = v[k] - m; q += d * d; }
                q = wave_sum(q); mean[t] = m; rstd[t] = rsqrtf(q * (1.0f / DR) + EPS);
            }
#pragma unroll 1
            for (int i = 0; i < 3; ++i) {
                const int c0 = (i * 64 + lane) * 8, g = c0 / 96;
                float vn[4][8];
                f32x4 lg0 = *(const f32x4*)(lng + c0), lg1 = *(const f32x4*)(lng + c0 + 4), lb0 = *(const f32x4*)(lnb + c0), lb1 = *(const f32x4*)(lnb + c0 + 4);
#pragma unroll
                for (int t = 0; t < 4; ++t) { const u32x4 x = *(const u32x4*)(BIG + (row0 + t) * LDBIG + DR + c0);
#pragma unroll
                    for (int k = 0; k < 4; ++k) { const float g0 = k < 2 ? lg0[2 * k] : lg1[2 * k - 4], g1 = k < 2 ? lg0[2 * k + 1] : lg1[2 * k - 3];
                        const float b0 = k < 2 ? lb0[2 * k] : lb1[2 * k - 4], b1 = k < 2 ? lb0[2 * k + 1] : lb1[2 * k - 3];
                        vn[t][2 * k] = (bflo(x[k]) - mean[t]) * rstd[t] * g0 + b0; vn[t][2 * k + 1] = (bfhi(x[k]) - mean[t]) * rstd[t] * g1 + b1; }
                    float* vo = P.out + O_VS + (((size_t)jl * 128 + sq) * 4 + t) * DR + c0;
                    *(f32x4*)vo = (f32x4){vn[t][0], vn[t][1], vn[t][2], vn[t][3]}; *(f32x4*)(vo + 4) = (f32x4){vn[t][4], vn[t][5], vn[t][6], vn[t][7]}; }
#pragma unroll
                for (int t = 0; t < 4; ++t) {
                    float mx[8]; const float bsv = bsp[g * 128 + t];
#pragma unroll
                    for (int k = 0; k < 8; ++k) mx[k] = bsv;
#pragma unroll
                    for (int s2 = 0; s2 < 4; ++s2) if (s2 <= t) { const float wv = wsp[((size_t)g * 128 + t) * 128 + s2];
#pragma unroll
                        for (int k = 0; k < 8; ++k) mx[k] += wv * vn[s2][k]; }
                    const u32x4 uu = *(const u32x4*)(BIG + (row0 + t) * LDBIG + c0);
                    u32x4 o;
#pragma unroll
                    for (int k = 0; k < 4; ++k) o[k] = cvt_pk_bf16(bflo(uu[k]) * mx[2 * k], bfhi(uu[k]) * mx[2 * k + 1]);
                    *(u32x4*)(Y + (row0 + t) * LDY + c0) = o;
                }
            }
            continue;
        }
        const int ci = (it - 16) >> 1, g0 = ((it - 16) & 1) * 8; const size_t row0 = (size_t)ci * 128;
        for (int rr = 0; rr < 16; ++rr) {
            const int r = 16 * w + rr; float v[24]; float s = 0.f;
#pragma unroll
            for (int i = 0; i < 3; ++i) { const u32x4 x = *(const u32x4*)(BIG + (row0 + r) * LDBIG + DR + (i * 64 + lane) * 8);
#pragma unroll
                for (int k = 0; k < 4; ++k) { v[i * 8 + 2 * k] = bflo(x[k]); v[i * 8 + 2 * k + 1] = bfhi(x[k]); s += v[i * 8 + 2 * k] + v[i * 8 + 2 * k + 1]; } }
            s = wave_sum(s); const float m = s * (1.0f / DR); float q = 0.f;
#pragma unroll
            for (int k = 0; k < 24; ++k) { const float d = v[k] - m; q += d * d; }
            q = wave_sum(q);
            if (lane == 0) { ST[2 * r] = m; ST[2 * r + 1] = rsqrtf(q * (1.0f / DR) + EPS); }
        }
        __syncthreads();
        for (int gi = 0; gi < 8; ++gi) {
            const int g = g0 + gi;
#pragma unroll
            for (int i = 0; i < 3; ++i) { const int idx = i * 512 + tid, r = idx / 12, q = idx % 12, c0 = 96 * g + 8 * q;
                const u32x4 x = *(const u32x4*)(BIG + (row0 + r) * LDBIG + DR + c0);
                const f32x4 lg0 = *(const f32x4*)(lng + c0), lg1 = *(const f32x4*)(lng + c0 + 4), lb0 = *(const f32x4*)(lnb + c0), lb1 = *(const f32x4*)(lnb + c0 + 4);
                const float m = ST[2 * r], rs = ST[2 * r + 1];
#pragma unroll
                for (int k = 0; k < 4; ++k) { const float ga = k < 2 ? lg0[2 * k] : lg1[2 * k - 4], gb = k < 2 ? lg0[2 * k + 1] : lg1[2 * k - 3];
                    const float ba = k < 2 ? lb0[2 * k] : lb1[2 * k - 4], bb = k < 2 ? lb0[2 * k + 1] : lb1[2 * k - 3];
                    const unsigned pk = cvt_pk_bf16((bflo(x[k]) - m) * rs * ga + ba, (bfhi(x[k]) - m) * rs * gb + bb);
                    VT[(8 * q + 2 * k) * 136 + r] = (bf16_t)(pk & 0xffffu); VT[(8 * q + 2 * k + 1) * 136 + r] = (bf16_t)(pk >> 16); } }
#pragma unroll
            for (int i = 0; i < 8; ++i) { const int idx = i * 512 + tid, t = idx >> 5, s4 = (idx & 31) * 4;
                f32x4 wv = (f32x4){0.f, 0.f, 0.f, 0.f};
                if (s4 <= t) wv = *(const f32x4*)(wsp + ((size_t)g * 128 + t) * 128 + s4);
                u32x2 o; o.x = cvt_pk_bf16(s4 <= t ? wv[0] : 0.f, s4 + 1 <= t ? wv[1] : 0.f); o.y = cvt_pk_bf16(s4 + 2 <= t ? wv[2] : 0.f, s4 + 3 <= t ? wv[3] : 0.f);
                *(LAS u32x2*)(WS + t * 136 + s4) = o; }
            __syncthreads();
            f32x4 acc[6];
#pragma unroll
            for (int dt = 0; dt < 6; ++dt) acc[dt] = (f32x4){0.f, 0.f, 0.f, 0.f};
            const int kmax = w >> 1;
            for (int kk = 0; kk <= kmax; ++kk) {
                const bf16x8 bw = *(const LAS bf16x8*)(WS + (16 * w + fr) * 136 + 32 * kk + 8 * fq);
#pragma unroll
                for (int dt = 0; dt < 6; ++dt) { const bf16x8 av = *(const LAS bf16x8*)(VT + (16 * dt + fr) * 136 + 32 * kk + 8 * fq);
                    acc[dt] = __builtin_amdgcn_mfma_f32_16x16x32_bf16(av, bw, acc[dt], 0, 0, 0); }
            }
            { const int t = 16 * w + fr; const size_t row = row0 + t; const float bsv = bsp[g * 128 + t];
#pragma unroll
                for (int dt = 0; dt < 6; ++dt) { const int c = 96 * g + 16 * dt + 4 * fq;
                    const u32x2 uu = *(const u32x2*)(BIG + row * LDBIG + c);
                    u32x2 o; o.x = cvt_pk_bf16(bflo(uu.x) * (acc[dt][0] + bsv), bfhi(uu.x) * (acc[dt][1] + bsv)); o.y = cvt_pk_bf16(bflo(uu.y) * (acc[dt][2] + bsv), bfhi(uu.y) * (acc[dt][3] + bsv));
                    *(u32x2*)(Y + row * LDY + c) = o; } }
            __syncthreads();
        }
    }
}

__global__ void __launch_bounds__(NTHREADS) fwd_megakernel(Params P) {
    extern __shared__ __attribute__((aligned(16))) unsigned char lds_raw[];
    LAS unsigned char* lds = (LAS unsigned char*)lds_raw;
    volatile LAS unsigned* MISC = (volatile LAS unsigned*)(lds + MISC_OFF);
    const int tid = threadIdx.x, G = gridDim.x, bid = blockIdx.x;
    if (tid < 16) MISC[tid] = 0u;
    __syncthreads();
    unsigned char* ws = P.ws;
    XcdBarrier bar = xcd_barrier_post((unsigned*)(ws + WS_CTL), MISC);
#define GRID_BAR() xcd_barrier(bar)
    bf16_t* HIN = (bf16_t*)(ws + WS_HIN); bf16_t* BIG = (bf16_t*)(ws + WS_BIG); bf16_t* Yb = (bf16_t*)(ws + WS_Y); float* MOD = (float*)(ws + WS_MOD);
    float* xout = P.out + O_Y;

    convert_transpose(lds, P.in[I_ADAW], (bf16_t*)(ws + WS_ADA), 1024, 6144, 4, G, bid);
    convert_transpose(lds, P.in[I_LWIN], (bf16_t*)(ws + WS_LIN), 1024, 3072, 2, G, bid);
    convert_transpose(lds, P.in[I_LWOUT], (bf16_t*)(ws + WS_LOUT), 1536, 1024, 2, G, bid);
    convert_transpose(lds, P.in[I_SWIN], (bf16_t*)(ws + WS_SIN), 1024, 3072, 2, G, bid);
    convert_transpose(lds, P.in[I_SWOUT], (bf16_t*)(ws + WS_SOUT), 1536, 1024, 2, G, bid);
    convert_transpose(lds, P.in[I_UP], (bf16_t*)(ws + WS_UP), 1024, 4096, 4, G, bid);
    convert_transpose(lds, P.in[I_DN], (bf16_t*)(ws + WS_DN), 4096, 1024, 4, G, bid);
    { bf16_t* WAT = (bf16_t*)(ws + WS_WAT); bf16_t* WXT = (bf16_t*)(ws + WS_WXT);
      for (int idx = bid * NTHREADS + tid; idx < 2 * 16 * 96 * 96; idx += G * NTHREADS) { const int m = idx / 9216, r = idx % 9216, j = r / 96, i = r % 96;
          WAT[idx] = (bf16_t)(cvt_pk_bf16(P.in[I_LWA][(size_t)m * 9216 + i * 96 + j], 0.f) & 0xffffu);
          WXT[idx] = (bf16_t)(cvt_pk_bf16(P.in[I_LWX][(size_t)m * 9216 + i * 96 + j], 0.f) & 0xffffu); }
      bf16_t* CA = (bf16_t*)(ws + WS_CA);
      for (int idx = bid * NTHREADS + tid; idx < 256 * 1024; idx += G * NTHREADS) { const int s = idx >> 10, d = idx & 1023;
          float c = 0.f; if (s < 8) c = P.in[I_CP][s * 1024 + d]; else if (s < NSEQ) c = P.in[I_CS][(s - 8) * 1024 + d];
          CA[idx] = (bf16_t)(cvt_pk_bf16(c / (1.0f + __expf(-c)), 0.f) & 0xffffu); } }
    cg::this_grid().sync();
    GRID_BAR();

    for (int st = 0; st < 30; ++st) {
        const int L = st < 2 ? 0 : (st - 2) / 7, sub = st < 2 ? st - 2 : (st - 2) % 7;
        const int jl = L >> 1; const bool lru = (L & 1) == 0;
        const float* ng = P.in[I_NG] + (size_t)L * 4 * 1024;
        const int mo = L * 6144;
        if (sub == -2 || sub == 0 || sub == 2 || sub == 4 || sub == 5) {
            pg8::Gemm g; pg8::EpiU E; E.perm = true; E.C = nullptr; E.nrows = 0; E.bias = nullptr; E.mode = 0; E.O = BIG; E.ldc = LDBIG;
            if (sub == -2) { g = pg8::Gemm{(const bf16_t*)(ws + WS_CA), (const bf16_t*)(ws + WS_ADA), 256, NMOD, 1024}; E.mode = 3; E.perm = false; E.C = MOD; E.ldc = NMOD; E.bias = P.in[I_ADAB]; E.nrows = NSEQ; }
            else if (sub == 0) { g = pg8::Gemm{HIN, (const bf16_t*)(ws + (lru ? WS_LIN : WS_SIN)) + (size_t)jl * 3072 * 1024, T, 3072, 1024}; if (!lru) { E.mode = 1; E.bias = P.in[I_SBIN] + (size_t)jl * 3072; } }
            else if (sub == 2) { g = pg8::Gemm{Yb, (const bf16_t*)(ws + (lru ? WS_LOUT : WS_SOUT)) + (size_t)jl * 1024 * 1536, T, 1024, 1536}; }
            else if (sub == 4) { g = pg8::Gemm{HIN, (const bf16_t*)(ws + WS_UP) + (size_t)L * 4096 * 1024, T, 4096, 1024}; E.mode = 2; }
            else { g = pg8::Gemm{BIG, (const bf16_t*)(ws + WS_DN) + (size_t)L * 4096 * 1024, T, 1024, 4096}; E.O = Yb; E.ldc = LDY; }
            pg8::StaticOrder S; S.init(g.M, g.N, G, bid);
            pg8::gemm_phase(lds, g, S, E);
        } else if (sub == 1) {
            if (lru) lru_core_phase(lds, P, jl, G, bid); else sgu_core_phase(lds, P, jl, G, bid);
        } else {
            const float* xP = xout; const float* xS = xout + (size_t)TP * D; const bf16_t* res = nullptr; int ldr = 0; const float* gA = nullptr; int gate_off = 0;
            const float* gB = ng; int sc_off = mo + 1024, sh_off = mo; bf16_t* ho = HIN;
            if (sub == -1) { xP = P.in[I_XP]; xS = P.in[I_XS]; }
            else if (sub == 3) { res = BIG; ldr = LDBIG; gA = ng + 1024; gate_off = mo + 2 * 1024; gB = ng + 2 * 1024; sc_off = mo + 4 * 1024; sh_off = mo + 3 * 1024; }
            else { res = Yb; ldr = LDY; gA = ng + 3 * 1024; gate_off = mo + 5 * 1024; gB = ng + 4 * 1024; sc_off = mo + 6144 + 1024; sh_off = mo + 6144; if (L == 3) { ho = nullptr; gB = ng; } }
            rowwise_phase(xP, xS, xout, res, ldr, gA, MOD, gate_off, gB, sc_off, sh_off, ho, G, bid);
        }
        if (st != 29) GRID_BAR();
    }
}

extern "C" void kernel_launch(void* const* d_in, const int* in_sizes, int n_in, void* d_out, int out_size, void* d_ws, size_t ws_size, hipStream_t stream) {
    static int grid = 0;
    if (grid == 0) {
        if (n_in != 27 || ws_size < WS_END) { fprintf(stderr, "kernel_launch: unexpected n_in %d / ws %zu (need %zu)\n", n_in, ws_size, (size_t)WS_END); grid = -1; return; }
        int dev = 0, cus = 0, per_cu = 0;
        hipGetDevice(&dev); hipDeviceGetAttribute(&cus, hipDeviceAttributeMultiprocessorCount, dev);
        if (hipFuncSetAttribute((const void*)fwd_megakernel, hipFuncAttributeMaxDynamicSharedMemorySize, LDS_BYTES) != hipSuccess) { fprintf(stderr, "kernel_launch: hipFuncSetAttribute failed\n"); grid = -1; return; }
        if (hipOccupancyMaxActiveBlocksPerMultiprocessor(&per_cu, (const void*)fwd_megakernel, NTHREADS, LDS_BYTES) != hipSuccess || per_cu < 1) { fprintf(stderr, "kernel_launch: occupancy query %d\n", per_cu); per_cu = 1; }
        (void)hipGetLastError();
        if (per_cu > 1) per_cu = 1;
        grid = cus * per_cu;
    }
    if (grid < 0) return;
    hipMemsetAsync((char*)d_ws + WS_CTL, 0, CTL_BYTES, stream);
    Params p{};
    for (int i = 0; i < 27; ++i) p.in[i] = (const float*)d_in[i];
    p.out = (float*)d_out; p.ws = (unsigned char*)d_ws;
    void* args[] = {&p};
    hipError_t e = hipLaunchCooperativeKernel((const void*)fwd_megakernel, dim3(grid), dim3(NTHREADS), args, LDS_BYTES, stream);
    if (e != hipSuccess) fprintf(stderr, "cooperative launch failed: %s (grid %d)\n", hipGetErrorString(e), grid);
}
```
